# Optimizing an MI355X kernel written in HIP

```python
import jax, jax.numpy as jnp
from jax import lax
import numpy as np

D_MODEL = 1024
BATCH = 4
SEQ = 4096
DEPTH = 1

N_MEM = 256
HEAD_DIM = 64
ATTN_WIDTH = D_MODEL // 2
CONV_WIDTH = D_MODEL // 4
XATTN_WIDTH = D_MODEL // 4
N_ATTN_HEADS = ATTN_WIDTH // HEAD_DIM
N_XATTN_HEADS = 4
XATTN_HEAD_DIM = XATTN_WIDTH // N_XATTN_HEADS
MIX_WIDTH = ATTN_WIDTH + CONV_WIDTH + XATTN_WIDTH
IN_PROJ_WIDTH = 3 * ATTN_WIDTH + 3 * CONV_WIDTH + XATTN_WIDTH
DILATED_PATTERNS = ((128, 1), (512, 4), (2048, 16))
CONV_K = 3
D_FF = 4 * D_MODEL
ROPE_THETA = 10000.0
EPS = 1e-6
NEG_INF = -1e30

kernel_name = "hybrid_dilated_attn_shortconv_memxattn_block"


def rms_norm(x, g):
    xf = x.astype(jnp.float32)
    y = xf * lax.rsqrt(jnp.mean(xf * xf, axis=-1, keepdims=True) + EPS)
    return (y * g.astype(jnp.float32)).astype(x.dtype)


def apply_rope(t, positions):
    dh = t.shape[-1]
    half = dh // 2
    inv_freq = jnp.float32(ROPE_THETA) ** (-(jnp.arange(half, dtype=jnp.float32) * 2.0 / dh))
    ang = positions.astype(jnp.float32)[..., None] * inv_freq
    cos = jnp.cos(ang)[:, :, None, :]
    sin = jnp.sin(ang)[:, :, None, :]
    tf = t.astype(jnp.float32)
    t1, t2 = tf[..., :half], tf[..., half:]
    out = jnp.concatenate([t1 * cos - t2 * sin, t1 * sin + t2 * cos], axis=-1)
    return out.astype(t.dtype)


def dilated_window_attention(q, k, v, window, dilation):
    B, S, H, Dh = q.shape
    L = S // dilation
    n_back = window // dilation
    blk = n_back
    nb = -(-L // blk)
    Lp = nb * blk

    def to_blocks(t):
        t = t.reshape(B, L, dilation, H, Dh).transpose(0, 2, 1, 3, 4)
        t = jnp.pad(t, ((0, 0), (0, 0), (0, Lp - L), (0, 0), (0, 0)))
        return t.reshape(B, dilation, nb, blk, H, Dh)

    qb, kb, vb = to_blocks(q), to_blocks(k), to_blocks(v)

    def with_prev(t):
        prev = jnp.pad(t, ((0, 0), (0, 0), (1, 0), (0, 0), (0, 0), (0, 0)))[:, :, :-1]
        return jnp.concatenate([prev, t], axis=3)

    kw, vw = with_prev(kb), with_prev(vb)
    scale = Dh ** -0.5
    s = jnp.einsum('bdnqhc,bdnkhc->bdnhqk', qb, kw,
                   preferred_element_type=jnp.float32) * scale
    qi = jnp.arange(blk)[:, None]
    kj = jnp.arange(2 * blk)[None, :]
    band = (kj >= qi) & (kj <= qi + n_back)
    valid = band[None] & ((jnp.arange(nb)[:, None, None] > 0) | (kj[None] >= blk))
    s = jnp.where(valid[None, None, :, None], s, NEG_INF)
    lse = jax.nn.logsumexp(s, axis=-1)
    p = jnp.exp(s - lse[..., None])
    o = jnp.einsum('bdnhqk,bdnkhc->bdnqhc', p.astype(v.dtype), vw,
                   preferred_element_type=jnp.float32)
    o = o.reshape(B, dilation, Lp, H, Dh)[:, :, :L]
    o = o.transpose(0, 2, 1, 3, 4).reshape(B, S, H, Dh)
    lse = lse.transpose(0, 1, 2, 4, 3).reshape(B, dilation, Lp, H)[:, :, :L]
    lse = lse.transpose(0, 2, 1, 3).reshape(B, S, H)
    return o, lse


def dilated_mixture_attention(q, k, v):
    outs, lses = [], []
    for window, dilation in DILATED_PATTERNS:
        o, lse = dilated_window_attention(q, k, v, window, dilation)
        outs.append(o)
        lses.append(lse)
    w = jax.nn.softmax(jnp.stack(lses, axis=0), axis=0)
    o = jnp.sum(w[..., None] * jnp.stack(outs, axis=0), axis=0)
    return o.astype(q.dtype)


def short_gated_conv(b_gate, c_gate, u, conv_w):
    z = c_gate * u
    S = z.shape[1]
    zp = jnp.pad(z, ((0, 0), (CONV_K - 1, 0), (0, 0)))
    y = zp[:, 0:S] * conv_w[0]
    for tap in range(1, CONV_K):
        y = y + zp[:, tap:tap + S] * conv_w[tap]
    return b_gate * y


def memory_cross_attention(qx, mem_kv):
    B, S, _ = qx.shape
    q = qx.reshape(B, S, N_XATTN_HEADS, XATTN_HEAD_DIM)
    km, vm = jnp.split(mem_kv, 2, axis=-1)
    km = km.reshape(B, -1, N_XATTN_HEADS, XATTN_HEAD_DIM)
    vm = vm.reshape(B, -1, N_XATTN_HEADS, XATTN_HEAD_DIM)
    s = jnp.einsum('bshc,bmhc->bhsm', q, km,
                   preferred_element_type=jnp.float32) * (XATTN_HEAD_DIM ** -0.5)
    p = jax.nn.softmax(s, axis=-1)
    o = jnp.einsum('bhsm,bmhc->bshc', p.astype(vm.dtype), vm)
    return o.reshape(B, S, XATTN_WIDTH)


def setup_inputs(seed: int = 0) -> dict:
    key = jax.random.key(seed)
    ks = jax.random.split(key, 20)
    f32 = jnp.float32

    def w(k, shape, fan_in):
        return jax.random.normal(k, shape, f32) * (fan_in ** -0.5)

    def gain(k, width):
        return 1.0 + 0.05 * jax.random.normal(k, (DEPTH, width), f32)

    x = jax.random.normal(ks[0], (BATCH, SEQ, D_MODEL), f32)
    mem = jax.random.normal(ks[1], (BATCH, N_MEM, D_MODEL), f32)
    offset = jax.random.randint(ks[2], (BATCH, 1), 0, 1024, dtype=jnp.int32)
    positions = offset + jnp.arange(SEQ, dtype=jnp.int32)[None, :]
    return {
        "x": x,
        "mem": mem,
        "positions": positions,
        "g_pre_mix": gain(ks[3], D_MODEL),
        "g_mem": gain(ks[4], D_MODEL),
        "w_in": w(ks[5], (DEPTH, D_MODEL, IN_PROJ_WIDTH), D_MODEL),
        "w_mem_kv": w(ks[6], (DEPTH, D_MODEL, 2 * XATTN_WIDTH), D_MODEL),
        "conv_w": w(ks[7], (DEPTH, CONV_K, CONV_WIDTH), CONV_K),
        "g_attn_out": gain(ks[8], ATTN_WIDTH),
        "g_conv_out": gain(ks[9], CONV_WIDTH),
        "g_xattn_out": gain(ks[10], XATTN_WIDTH),
        "w_out": w(ks[11], (DEPTH, MIX_WIDTH, D_MODEL), MIX_WIDTH),
        "g_post_mix": gain(ks[12], D_MODEL),
        "g_pre_mlp": gain(ks[13], D_MODEL),
        "w_up": w(ks[14], (DEPTH, D_MODEL, D_FF), D_MODEL),
        "w_down": w(ks[15], (DEPTH, D_FF, D_MODEL), D_FF),
        "g_post_mlp": gain(ks[16], D_MODEL),
    }


def reference(x, mem, positions, g_pre_mix, g_mem, w_in, w_mem_kv, conv_w,
              g_attn_out, g_conv_out, g_xattn_out, w_out, g_post_mix,
              g_pre_mlp, w_up, w_down, g_post_mlp):
    B, S, _ = x.shape
    a0 = ATTN_WIDTH
    c0 = 3 * ATTN_WIDTH
    x0 = 3 * ATTN_WIDTH + 3 * CONV_WIDTH
    for l in range(DEPTH):
        h = rms_norm(x, g_pre_mix[l])
        proj = jnp.einsum('bsd,de->bse', h, w_in[l])

        q = proj[..., 0:a0].reshape(B, S, N_ATTN_HEADS, HEAD_DIM)
        k = proj[..., a0:2 * a0].reshape(B, S, N_ATTN_HEADS, HEAD_DIM)
        v = proj[..., 2 * a0:3 * a0].reshape(B, S, N_ATTN_HEADS, HEAD_DIM)
        q = apply_rope(q, positions)
        k = apply_rope(k, positions)
        y_attn = dilated_mixture_attention(q, k, v).reshape(B, S, ATTN_WIDTH)

        b_gate = proj[..., c0:c0 + CONV_WIDTH]
        c_gate = proj[..., c0 + CONV_WIDTH:c0 + 2 * CONV_WIDTH]
        u = proj[..., c0 + 2 * CONV_WIDTH:c0 + 3 * CONV_WIDTH]
        y_conv = short_gated_conv(b_gate, c_gate, u, conv_w[l])

        qx = proj[..., x0:x0 + XATTN_WIDTH]
        mem_kv = jnp.einsum('bmd,de->bme', rms_norm(mem, g_mem[l]), w_mem_kv[l])
        y_x = memory_cross_attention(qx, mem_kv)

        y = jnp.concatenate([rms_norm(y_attn, g_attn_out[l]),
                             rms_norm(y_conv, g_conv_out[l]),
                             rms_norm(y_x, g_xattn_out[l])], axis=-1)
        y = jnp.einsum('bse,ed->bsd', y, w_out[l])
        x = x + rms_norm(y, g_post_mix[l])

        h2 = rms_norm(x, g_pre_mlp[l])
        f = jnp.square(jax.nn.relu(jnp.einsum('bsd,df->bsf', h2, w_up[l])))
        f = jnp.einsum('bsf,fd->bsd', f, w_down[l])
        x = x + rms_norm(f, g_post_mlp[l])
    return x
```

```cpp
#include <hip/hip_runtime.h>
#include <hip/hip_cooperative_groups.h>
#include <cstdio>
#include <cstdint>
namespace cg = cooperative_groups;
namespace pg8 {
#define PG8_LAS __attribute__((address_space(3)))
typedef unsigned short bf16_t;
typedef short bf16x8 __attribute__((ext_vector_type(8)));
typedef float f32x4 __attribute__((ext_vector_type(4)));
typedef unsigned u32x4 __attribute__((ext_vector_type(4)));
constexpr int BM = 256, BK = 64, HALF = 128, HTB = HALF * BK * 2  , STAGE_BYTES = 8 * HTB, NXCD = 8, WGM = 8;

__host__ __device__ __forceinline__ int lds_byte(int r, int c) { const int st = (r >> 4) * 2 + (c >> 5), rr = r & 15, cc = c & 31, ob = rr * 64 + cc * 2; return st * 1024 + (ob ^ (((ob >> 9) & 1) << 5)); }
__host__ __device__ __forceinline__ void stage_rc(int b, int& R, int& C) { const int st = b / 1024, sb = b % 1024, swz = sb ^ (((sb >> 9) & 1) << 5); R = (st >> 1) * 16 + swz / 64; C = (st & 1) * 32 + (swz % 64) / 2; }
__host__ __device__ __forceinline__ int perm32(int rho) { const int n = rho >> 4, i = rho & 15; return 8 * (i >> 2) + 4 * n + (i & 3); }

struct Unit { int pm, pn; };
struct Gemm { const bf16_t* A; const bf16_t* Bt; int M, N, K; };

struct StaticOrder {
    int nM, nN, nwg, G, c;
    __host__ __device__ void init(int M, int N, int G_, int c_) { nM = M / BM; nN = N / BM; nwg = nM * nN; G = G_; c = c_; }
    __host__ __device__ bool next(int i, Unit& u) const {
        const long L = (long)i * G + c; if (L >= nwg) return false;
        int wgid = (int)L; { const int q = nwg / NXCD, r = nwg % NXCD, xcd = wgid % NXCD, off = wgid / NXCD; wgid = (xcd < r ? xcd * (q + 1) : r * (q + 1) + (xcd - r) * q) + off; }
        const int nig = WGM * nN, gid = wgid / nig, fm = gid * WGM, gsz = (nM - fm) < WGM ? (nM - fm) : WGM;
        u.pm = fm + ((wgid % nig) % gsz); u.pn = (wgid % nig) / gsz; return true;
    }
    __device__ __forceinline__ void a_ready(const Unit&) const {}
    __device__ __forceinline__ void done(const Unit&) const {}
};
__device__ __forceinline__ unsigned cvt_pk_bf16(float lo, float hi) { unsigned r; asm volatile("v_cvt_pk_bf16_f32 %0, %1, %2" : "=v"(r) : "v"(lo), "v"(hi)); return r; }
template <class Epi, class Sched, bool ALIGN_EPI = false, bool SP2 = false>
__device__ __forceinline__ void gemm_phase(PG8_LAS unsigned char* lds, const Gemm g, const Sched& S, const Epi& E) {
    const int tid = threadIdx.x, wid = __builtin_amdgcn_readfirstlane(tid >> 6), lane = tid & 63, wr = wid >> 2, wc = wid & 3, fr = lane & 15, fq = lane >> 4;
    const int K = g.K, nt = K / BK;
    unsigned voffA[2], voffB[2];
#pragma unroll
    for (int i = 0; i < 2; ++i) { int R, C; stage_rc(tid * 16 + i * 8192, R, C); const int Rb = Epi::PERM ? ((R & ~31) + perm32(R & 31)) : R;
        voffA[i] = (unsigned)(R * K + C) * 2u; voffB[i] = (unsigned)(Rb * K + C) * 2u; }
    const size_t kstep = (size_t)(BK * 2);
    const size_t hstep = (size_t)HALF * K * 2;
    const size_t tstep = 2 * hstep;
    const unsigned ldsw = (unsigned)wid * 1024u;
    const int aoff = lds_byte(wr * 64 + fr, fq * 8), boff = lds_byte(wc * 32 + fr, fq * 8);
#define PG8_SA(b, h) (((b) * 2 + (h)) * HTB)
#define PG8_SB(b, h) ((4 + (b) * 2 + (h)) * HTB)
#define PG8_STAGE(bufoff, gbase, voff) do { _Pragma("unroll") for (int _i = 0; _i < 2; ++_i) \
        __builtin_amdgcn_global_load_lds((const unsigned*)((const char*)(gbase) + (voff)[_i]), (PG8_LAS unsigned*)(lds + (bufoff) + ldsw + _i * 8192), 16, 0, 0); } while (0)
#define PG8_LDA(dst, b, h) do { _Pragma("unroll") for (int m = 0; m < 4; ++m) _Pragma("unroll") for (int k = 0; k < 2; ++k) dst[m][k] = *(const PG8_LAS bf16x8*)(lds + PG8_SA(b, h) + aoff + m * 2048 + k * 1024); } while (0)
#define PG8_LDB(dst, b, h) do { _Pragma("unroll") for (int n = 0; n < 2; ++n) _Pragma("unroll") for (int k = 0; k < 2; ++k) dst[n][k] = *(const PG8_LAS bf16x8*)(lds + PG8_SB(b, h) + boff + n * 2048 + k * 1024); } while (0)
#define PG8_MMA(ai, bj, At, Bt) do { __builtin_amdgcn_s_setprio(1); _Pragma("unroll") for (int m = 0; m < 4; ++m) _Pragma("unroll") for (int n = 0; n < 2; ++n) _Pragma("unroll") for (int k = 0; k < 2; ++k) \
        acc[ai][bj][m][n] = __builtin_amdgcn_mfma_f32_16x16x32_bf16(Bt[n][k], At[m][k], acc[ai][bj][m][n], 0, 0, 0); __builtin_amdgcn_s_setprio(0); } while (0)
#define PG8_WAIT_V(n) asm volatile("s_waitcnt vmcnt(" #n ")" ::: "memory")
#define PG8_WAIT_L(n) asm volatile("s_waitcnt lgkmcnt(" #n ")" ::: "memory")
#define PG8_BAR __builtin_amdgcn_s_barrier()
#define PG8_SCHED __builtin_amdgcn_sched_barrier(0)
    Unit cur, nxt; int ui = 0;
    if (!S.next(0, cur)) return;
    f32x4 acc[2][2][4][2];
#pragma unroll
    for (int a = 0; a < 2; ++a)
#pragma unroll
        for (int b = 0; b < 2; ++b)
#pragma unroll
            for (int m = 0; m < 4; ++m)
#pragma unroll
                for (int n = 0; n < 2; ++n) acc[a][b][m][n] = (f32x4){0.f, 0.f, 0.f, 0.f};
    bf16x8 At[4][2], B0[2][2], B1[2][2];
    const char* cA = (const char*)g.A + (size_t)cur.pm * tstep; const char* cB = (const char*)g.Bt + (size_t)cur.pn * tstep;
    S.a_ready(cur);
    if constexpr (SP2) {
        PG8_STAGE(PG8_SB(0, 0), cB, voffB); PG8_STAGE(PG8_SB(0, 1), cB + hstep, voffB); PG8_STAGE(PG8_SA(0, 0), cA, voffA); PG8_STAGE(PG8_SA(0, 1), cA + hstep, voffA);
        if (wr == 1) PG8_BAR;
        PG8_WAIT_V(2); PG8_BAR;
        PG8_STAGE(PG8_SB(1, 0), cB + kstep, voffB); PG8_STAGE(PG8_SA(1, 0), cA + kstep, voffA); PG8_STAGE(PG8_SB(1, 1), cB + hstep + kstep, voffB);
        PG8_WAIT_V(6); PG8_BAR;
    } else {
        PG8_STAGE(PG8_SB(0, 0), cB, voffB); PG8_STAGE(PG8_SA(0, 0), cA, voffA); PG8_STAGE(PG8_SB(0, 1), cB + hstep, voffB); PG8_STAGE(PG8_SA(0, 1), cA + hstep, voffA);
        if (wr == 1) PG8_BAR;
        PG8_WAIT_V(4); PG8_BAR;
        PG8_STAGE(PG8_SB(1, 0), cB + kstep, voffB); PG8_STAGE(PG8_SA(1, 0), cA + kstep, voffA); PG8_STAGE(PG8_SB(1, 1), cB + hstep + kstep, voffB);
        PG8_WAIT_V(6); PG8_BAR;
    }
    for (;;) {
        const bool has_next = S.next(ui + 1, nxt);
        const char* nA = has_next ? (const char*)g.A + (size_t)nxt.pm * tstep : cA; const char* nB = has_next ? (const char*)g.Bt + (size_t)nxt.pn * tstep : cB;
        for (int t = 0; t < nt; t += 2) {
            const bool last = (t == nt - 2);
            const char* a1 = cA + (size_t)(t + 1) * kstep;
            const char* a2 = last ? nA : cA + (size_t)(t + 2) * kstep; const char* b2 = last ? nB : cB + (size_t)(t + 2) * kstep;
            const char* a3 = a2 + kstep; const char* b3 = b2 + kstep;
            if (last && has_next) S.a_ready(nxt);
            if constexpr (SP2) {
            PG8_LDB(B0, 0, 0); PG8_LDB(B1, 0, 1); PG8_SCHED; PG8_LDA(At, 0, 0); PG8_STAGE(PG8_SA(1, 1), a1 + hstep, voffA);
            PG8_WAIT_V(8); PG8_WAIT_L(0); PG8_BAR; PG8_MMA(0, 0, At, B0); PG8_MMA(0, 1, At, B1); PG8_BAR; PG8_SCHED;
            PG8_LDA(At, 0, 1); PG8_STAGE(PG8_SB(0, 0), b2, voffB); PG8_STAGE(PG8_SB(0, 1), b2 + hstep, voffB); PG8_STAGE(PG8_SA(0, 0), a2, voffA);
            PG8_WAIT_V(8); PG8_WAIT_L(0); PG8_BAR; PG8_MMA(1, 0, At, B0); PG8_MMA(1, 1, At, B1); PG8_BAR; PG8_SCHED;
            PG8_LDB(B0, 1, 0); PG8_LDB(B1, 1, 1); PG8_SCHED; PG8_LDA(At, 1, 0); PG8_STAGE(PG8_SA(0, 1), a2 + hstep, voffA);
            PG8_WAIT_V(8); PG8_WAIT_L(0); PG8_BAR; PG8_MMA(0, 0, At, B0); PG8_MMA(0, 1, At, B1); PG8_BAR; PG8_SCHED;
            PG8_LDA(At, 1, 1); PG8_STAGE(PG8_SB(1, 0), b3, voffB); PG8_STAGE(PG8_SB(1, 1), b3 + hstep, voffB); PG8_STAGE(PG8_SA(1, 0), a3, voffA);
            PG8_WAIT_V(8); PG8_WAIT_L(0); PG8_BAR; PG8_MMA(1, 0, At, B0); PG8_MMA(1, 1, At, B1); PG8_BAR; PG8_SCHED;
            } else {
            PG8_LDB(B0, 0, 0); PG8_SCHED; PG8_LDA(At, 0, 0); PG8_STAGE(PG8_SA(1, 1), a1 + hstep, voffA);
            PG8_WAIT_L(8); PG8_BAR; PG8_WAIT_L(0); PG8_MMA(0, 0, At, B0); PG8_BAR; PG8_SCHED;
            PG8_LDB(B1, 0, 1); PG8_STAGE(PG8_SB(0, 0), b2, voffB);
            PG8_BAR; PG8_WAIT_L(0); PG8_MMA(0, 1, At, B1); PG8_BAR;
            PG8_LDA(At, 0, 1); PG8_STAGE(PG8_SA(0, 0), a2, voffA);
            PG8_BAR; PG8_WAIT_L(0); PG8_MMA(1, 0, At, B0); PG8_BAR; PG8_SCHED;
            PG8_STAGE(PG8_SB(0, 1), b2 + hstep, voffB);
            PG8_WAIT_V(6); PG8_BAR; PG8_MMA(1, 1, At, B1); PG8_BAR;
            PG8_LDB(B0, 1, 0); PG8_SCHED; PG8_LDA(At, 1, 0); PG8_STAGE(PG8_SA(0, 1), a2 + hstep, voffA);
            PG8_WAIT_L(8); PG8_BAR; PG8_WAIT_L(0); PG8_MMA(0, 0, At, B0); PG8_BAR; PG8_SCHED;
            PG8_LDB(B1, 1, 1); PG8_STAGE(PG8_SB(1, 0), b3, voffB);
            PG8_BAR; PG8_WAIT_L(0); PG8_MMA(0, 1, At, B1); PG8_BAR;
            PG8_LDA(At, 1, 1); PG8_STAGE(PG8_SA(1, 0), a3, voffA);
            PG8_BAR; PG8_WAIT_L(0); PG8_MMA(1, 0, At, B0); PG8_BAR; PG8_SCHED;
            PG8_STAGE(PG8_SB(1, 1), b3 + hstep, voffB);
            PG8_WAIT_V(6); PG8_BAR; PG8_MMA(1, 1, At, B1); PG8_BAR;
            }
        }
        if constexpr (ALIGN_EPI) { if (wr == 0) PG8_BAR; }
        if constexpr (!Epi::AFTER_DRAIN) { E(acc, cur, wr, wc, fr, fq); S.done(cur); }
        if (!has_next) break;
#pragma unroll
        for (int a = 0; a < 2; ++a)
#pragma unroll
            for (int b = 0; b < 2; ++b)
#pragma unroll
                for (int m = 0; m < 4; ++m)
#pragma unroll
                    for (int n = 0; n < 2; ++n) acc[a][b][m][n] = (f32x4){0.f, 0.f, 0.f, 0.f};
        cur = nxt; cA = nA; cB = nB; ++ui;
        if constexpr (ALIGN_EPI) { if (wr == 1) PG8_BAR; }
    }
    PG8_WAIT_V(0);
    if constexpr (!ALIGN_EPI) { if (wr == 0) PG8_BAR; }
    PG8_BAR;
    if constexpr (Epi::AFTER_DRAIN) { E.fused(acc, cur, wr, wc, fr, fq, lds, wid, lane); S.done(cur); }
#undef PG8_SA
#undef PG8_SB
#undef PG8_STAGE
#undef PG8_LDA
#undef PG8_LDB
#undef PG8_MMA
#undef PG8_WAIT_V
#undef PG8_WAIT_L
#undef PG8_BAR
#undef PG8_SCHED
}
}

#ifndef MK_N_LAUNCHES
#define MK_N_LAUNCHES 9
#endif
constexpr int NWAVES = 8, NTHR = NWAVES * 64;
constexpr int DM = 1024, BATCH = 4, SEQ = 4096, M = BATCH * SEQ, NMEM = 256, MMEM = BATCH * NMEM;
constexpr int NPROJ = 2560, NMKV = 512, FF = 4096;
constexpr int C_K = 512, C_V = 1024, C_B = 1536, C_C = 1792, C_U = 2048, C_QX = 2304;
constexpr float EPS = 1e-6f;
constexpr float QSCALE = 0.125f * 1.4426950408889634f;
constexpr int NPH = 9;

constexpr size_t MiB = 1u << 20;
constexpr size_t WS_WIN = 1 * MiB;
constexpr size_t WS_WOUT = 7 * MiB;
constexpr size_t WS_WUP = 9 * MiB;
constexpr size_t WS_WDN = 17 * MiB;
constexpr size_t WS_ROPE = 25 * MiB;
constexpr size_t WS_MKV = 29 * MiB;
constexpr size_t WS_LSE = 30 * MiB;
constexpr size_t WS_XN = 32 * MiB;
constexpr size_t WS_H2 = 32 * MiB;
constexpr size_t WS_PROJ = 66 * MiB;
constexpr size_t WS_OG = 146 * MiB;
constexpr size_t WS_YX = 194 * MiB;
constexpr size_t WS_Y = 202 * MiB;
constexpr size_t WS_YO = 66 * MiB;
constexpr size_t WS_HB = 64 * MiB;
constexpr size_t WS_F = 192 * MiB;
constexpr size_t WS_END = 256 * MiB;

constexpr int LDS_BYTES = 147456;

#define LAS __attribute__((address_space(3)))
typedef unsigned short bf16;
typedef unsigned u32x4 __attribute__((ext_vector_type(4)));
typedef unsigned u32x2 __attribute__((ext_vector_type(2)));
typedef float f32x4 __attribute__((ext_vector_type(4)));
typedef float f32x16 __attribute__((ext_vector_type(16)));
typedef short bf16x8 __attribute__((ext_vector_type(8)));
typedef short s16x4 __attribute__((ext_vector_type(4)));
typedef float f32x2_t __attribute__((ext_vector_type(2)));
typedef __bf16 bf16x2_t __attribute__((ext_vector_type(2)));
#define LDS_WAIT() asm volatile("s_waitcnt lgkmcnt(0)" ::: "memory")

__device__ __forceinline__ unsigned pk2(float lo, float hi) { f32x2_t v = {lo, hi}; bf16x2_t b = __builtin_convertvector(v, bf16x2_t); return __builtin_bit_cast(unsigned, b); }
__device__ __forceinline__ float bflo(unsigned u) { return __uint_as_float(u << 16); }
__device__ __forceinline__ float bfhi(unsigned u) { return __uint_as_float(u & 0xffff0000u); }
__device__ __forceinline__ float wave_sum(float v) {
#pragma unroll
    for (int o = 1; o < 64; o <<= 1) v += __shfl_xor(v, o);
    return v;
}

template <class F> struct EpiAdapt {
    static constexpr bool PERM = true, AFTER_DRAIN = false;
    F f;
    __device__ __forceinline__ void operator()(const pg8::f32x4 (&acc)[2][2][4][2], const pg8::Unit& u, int wr, int wc, int fr, int fq) const {
        const int row0 = u.pm * 256 + wr * 64 + fr, col0 = u.pn * 256 + wc * 32 + 8 * fq;
#pragma unroll
        for (int ai = 0; ai < 2; ++ai)
#pragma unroll
            for (int m = 0; m < 4; ++m)
#pragma unroll
                for (int bj = 0; bj < 2; ++bj) f(row0 + ai * 128 + m * 16, col0 + bj * 128, acc[ai][bj][m][0], acc[ai][bj][m][1]);
    }
};
__device__ __forceinline__ void store_bf16x8(bf16* p, f32x4 a, f32x4 b) { u32x4 w; w.x = pk2(a[0], a[1]); w.y = pk2(a[2], a[3]); w.z = pk2(b[0], b[1]); w.w = pk2(b[2], b[3]); *(u32x4*)p = w; }

struct FInProj {
    bf16* proj; bf16* mkv; const float* rope;
    __device__ __forceinline__ void operator()(int row, int col, f32x4 a, f32x4 b) const {
        if (col >= NPROJ) { store_bf16x8(mkv + (size_t)(row - M) * NMKV + (col - NPROJ), a, b); return; }
        if (col < C_V) {
            const int i0 = (col & 63) >> 1;
            const f32x4 cs0 = *(const f32x4*)(rope + ((size_t)row * 32 + i0) * 2), cs1 = *(const f32x4*)(rope + ((size_t)row * 32 + i0 + 2) * 2);
            f32x4 ra, rb;
            ra[0] = a[0] * cs0[0] - a[1] * cs0[1]; ra[1] = a[0] * cs0[1] + a[1] * cs0[0];
            ra[2] = a[2] * cs0[2] - a[3] * cs0[3]; ra[3] = a[2] * cs0[3] + a[3] * cs0[2];
            rb[0] = b[0] * cs1[0] - b[1] * cs1[1]; rb[1] = b[0] * cs1[1] + b[1] * cs1[0];
            rb[2] = b[2] * cs1[2] - b[3] * cs1[3]; rb[3] = b[2] * cs1[3] + b[3] * cs1[2];
            a = ra; b = rb;
        }
        store_bf16x8(proj + (size_t)row * NPROJ + col, a, b);
    }
};
struct FF32 { float* C; int ldc;
    __device__ __forceinline__ void operator()(int row, int col, f32x4 a, f32x4 b) const { float* p = C + (size_t)row * ldc + col; *(f32x4*)p = a; *(f32x4*)(p + 4) = b; } };
struct FRelu2 { bf16* C; int ldc;
    __device__ __forceinline__ void operator()(int row, int col, f32x4 a, f32x4 b) const {
#pragma unroll
        for (int e = 0; e < 4; ++e) { const float x = fmaxf(a[e], 0.f), y = fmaxf(b[e], 0.f); a[e] = x * x; b[e] = y * y; }
        store_bf16x8(C + (size_t)row * ldc + col, a, b); } };

struct SchedInProj {
    pg8::StaticOrder so; int G, c;
    __device__ void init(int G_, int c_) { so.init(M, NPROJ, G_, c_); G = G_; c = c_; }
    __device__ bool next(int i, pg8::Unit& u) const {
        const long L = (long)i * G + c;
        if (L < 640) return so.next(i, u);
        if (L < 648) { const int e = (int)L - 640; u.pm = 64 + (e >> 1); u.pn = 10 + (e & 1); return true; }
        return false;
    }
    __device__ __forceinline__ void a_ready(const pg8::Unit&) const {}
    __device__ __forceinline__ void done(const pg8::Unit&) const {}
};

template <bool PERMQK>
__device__ __forceinline__ void transpose_item(const float* W, int K, int N, bf16* WT, LAS float* scr, int item, int lane) {
    const int nblk = N / 32, kb = item / nblk, nb = item % nblk, k0 = 64 * kb, n0 = 32 * nb;
#pragma unroll 8
    for (int i = 0; i < 32; ++i) { const int kk = 2 * i + (lane >> 5); scr[kk * 33 + (lane & 31)] = W[(size_t)(k0 + kk) * N + n0 + (lane & 31)]; }
    LDS_WAIT(); asm volatile("" ::: "memory");
    const int c = lane & 7;
#pragma unroll
    for (int j = 0; j < 4; ++j) { const int n = (lane >> 3) + 8 * j; const LAS float* s = scr + (8 * c) * 33 + n;
        u32x4 o; o.x = pk2(s[0 * 33], s[1 * 33]); o.y = pk2(s[2 * 33], s[3 * 33]); o.z = pk2(s[4 * 33], s[5 * 33]); o.w = pk2(s[6 * 33], s[7 * 33]);
        const int col = n0 + n; int row = col;
        if (PERMQK && col < C_V) { const int cc = col & 63; row = (col & ~63) + (cc < 32 ? 2 * cc : 2 * (cc - 32) + 1); }
        *(u32x4*)(WT + (size_t)row * K + k0 + 8 * c) = o; }
    LDS_WAIT(); asm volatile("" ::: "memory");
}
__device__ __forceinline__ void rms_row_to_bf16(const float* xrow, const float* g, bf16* orow, int lane) {
    const f32x4* xr = (const f32x4*)xrow + lane; const f32x4* gr = (const f32x4*)g + lane;
    f32x4 v[4]; float s = 0.f;
#pragma unroll
    for (int j = 0; j < 4; ++j) { v[j] = xr[64 * j]; s += (v[j].x * v[j].x + v[j].y * v[j].y) + (v[j].z * v[j].z + v[j].w * v[j].w); }
    const float rstd = 1.0f / sqrtf(wave_sum(s) * (1.f / DM) + EPS);
    u32x2* o8 = (u32x2*)orow + lane;
#pragma unroll
    for (int j = 0; j < 4; ++j) { const f32x4 gg = gr[64 * j]; u32x2 w; w.x = pk2(v[j].x * rstd * gg.x, v[j].y * rstd * gg.y); w.y = pk2(v[j].z * rstd * gg.z, v[j].w * rstd * gg.w); o8[64 * j] = w; }
}

constexpr int VRS = 144;
constexpr int VSTAGE_BYTES = 32 * VRS;
__device__ __forceinline__ int crow(int r, int hi) { return (r & 3) + 8 * (r >> 2) + 4 * hi; }
typedef short v4i16_t __attribute__((ext_vector_type(4)));
__device__ __forceinline__ s16x4 vtr(LAS const char* p) { return __builtin_bit_cast(s16x4, __builtin_amdgcn_ds_read_tr16_b64_v4i16((LAS v4i16_t*)p)); }

__device__ __forceinline__ void attn_core(const bf16* qrow, const bf16* kp, const bf16* vp, long kstride, int ntile, int jlo, int jhi, LAS char* vlds, int lane, f32x16 (&o)[2], float& lse2) {
    const int q = lane & 31, hi = lane >> 5;
    bf16x8 qf[4];
#pragma unroll
    for (int kk = 0; kk < 4; ++kk) qf[kk] = *(const bf16x8*)(qrow + 16 * kk + 8 * hi);
    float m = -1e30f, l = 0.f;
#pragma unroll
    for (int r = 0; r < 16; ++r) { o[0][r] = 0.f; o[1][r] = 0.f; }
    const int vkey = lane >> 3, vch = lane & 7;
    const int trbase = (4 * hi + ((lane & 15) >> 2)) * VRS + (16 * ((lane >> 4) & 1) + 4 * (lane & 3)) * 2;
    const bf16* kl = kp + (long)q * kstride + 8 * hi;
    const bf16* vl = vp + (long)vkey * kstride + 8 * vch;
    bf16x8 kf[4]; u32x4 vv[4];
#pragma unroll
    for (int kk = 0; kk < 4; ++kk) kf[kk] = *(const bf16x8*)(kl + 16 * kk);
#pragma unroll
    for (int i = 0; i < 4; ++i) vv[i] = *(const u32x4*)(vl + (long)(8 * i) * kstride);
    for (int j = 0; j < ntile; ++j) {
#pragma unroll
        for (int i = 0; i < 4; ++i) *(LAS u32x4*)(vlds + (8 * i + vkey) * VRS + vch * 16) = vv[i];
        bf16x8 kc[4];
#pragma unroll
        for (int kk = 0; kk < 4; ++kk) kc[kk] = kf[kk];
        if (j + 1 < ntile) {
            kl += 32 * kstride; vl += 32 * kstride;
#pragma unroll
            for (int kk = 0; kk < 4; ++kk) kf[kk] = *(const bf16x8*)(kl + 16 * kk);
#pragma unroll
            for (int i = 0; i < 4; ++i) vv[i] = *(const u32x4*)(vl + (long)(8 * i) * kstride);
        }
        f32x16 s;
#pragma unroll
        for (int r = 0; r < 16; ++r) s[r] = 0.f;
#pragma unroll
        for (int kk = 0; kk < 4; ++kk) s = __builtin_amdgcn_mfma_f32_32x32x16_bf16(kc[kk], qf[kk], s, 0, 0, 0);
#pragma unroll
        for (int r = 0; r < 16; ++r) s[r] *= QSCALE;
        if (j == jlo) {
#pragma unroll
            for (int r = 0; r < 16; ++r) if (crow(r, hi) < q) s[r] = -INFINITY;
        }
        if (j == jhi) {
#pragma unroll
            for (int r = 0; r < 16; ++r) if (crow(r, hi) > q) s[r] = -INFINITY;
        }
        float mx = s[0];
#pragma unroll
        for (int r = 1; r < 16; ++r) mx = fmaxf(mx, s[r]);
        mx = fmaxf(mx, __shfl_xor(mx, 32));
        const float mn = fmaxf(m, mx);
        const float alpha = __builtin_amdgcn_exp2f(m - mn);
        m = mn;
        float ps = 0.f;
#pragma unroll
        for (int r = 0; r < 16; ++r) { s[r] = __builtin_amdgcn_exp2f(s[r] - mn); ps += s[r]; }
        ps += __shfl_xor(ps, 32);
        l = l * alpha + ps;
#pragma unroll
        for (int r = 0; r < 16; ++r) { o[0][r] *= alpha; o[1][r] *= alpha; }
        u32x4 pw0, pw1;
        pw0.x = pk2(s[0], s[1]); pw0.y = pk2(s[2], s[3]); pw0.z = pk2(s[4], s[5]); pw0.w = pk2(s[6], s[7]);
        pw1.x = pk2(s[8], s[9]); pw1.y = pk2(s[10], s[11]); pw1.z = pk2(s[12], s[13]); pw1.w = pk2(s[14], s[15]);
        const bf16x8 pf0 = __builtin_bit_cast(bf16x8, pw0), pf1 = __builtin_bit_cast(bf16x8, pw1);
        asm volatile("" ::: "memory");
#pragma unroll
        for (int c = 0; c < 2; ++c) {
            const LAS char* vb = vlds + trbase + c * 64;
            const s16x4 a0 = vtr(vb), a1 = vtr(vb + 8 * VRS), b0 = vtr(vb + 16 * VRS), b1 = vtr(vb + 24 * VRS);
            const bf16x8 vf0 = (bf16x8){a0[0], a0[1], a0[2], a0[3], a1[0], a1[1], a1[2], a1[3]};
            const bf16x8 vf1 = (bf16x8){b0[0], b0[1], b0[2], b0[3], b1[0], b1[1], b1[2], b1[3]};
            o[c] = __builtin_amdgcn_mfma_f32_32x32x16_bf16(vf0, pf0, o[c], 0, 0, 0);
            o[c] = __builtin_amdgcn_mfma_f32_32x32x16_bf16(vf1, pf1, o[c], 0, 0, 0);
        }
        asm volatile("" ::: "memory");
    }
    const float inv = 1.0f / l;
#pragma unroll
    for (int r = 0; r < 16; ++r) { o[0][r] *= inv; o[1][r] *= inv; }
    lse2 = m + __builtin_amdgcn_logf(l);
}
__device__ __forceinline__ void attn_store(bf16* orow, const f32x16 (&o)[2], int hi) {
#pragma unroll
    for (int c = 0; c < 2; ++c)
#pragma unroll
        for (int g = 0; g < 4; ++g) { u32x2 w; w.x = pk2(o[c][4 * g], o[c][4 * g + 1]); w.y = pk2(o[c][4 * g + 2], o[c][4 * g + 3]); *(u32x2*)(orow + 32 * c + 8 * g + 4 * hi) = w; }
}

struct Args { const float* in[17]; float* out; unsigned char* ws; int ph_lo, ph_hi; };

__global__ void __launch_bounds__(NTHR, 2) mega(Args a) {
    extern __shared__ __attribute__((aligned(16))) unsigned char lds_raw[];
    LAS unsigned char* lds = (LAS unsigned char*)lds_raw;
    const int tid = threadIdx.x, lane = tid & 63, wave = __builtin_amdgcn_readfirstlane(tid >> 6);
    const int G = gridDim.x, bx = blockIdx.x;
    const int gw = bx * NWAVES + wave, NGW = G * NWAVES;
    unsigned char* ws = a.ws;
    const float* x = a.in[0]; const float* mem = a.in[1]; const int* pos = (const int*)a.in[2];
    const float* g_pre_mix = a.in[3]; const float* g_mem = a.in[4]; const float* w_in = a.in[5]; const float* w_mkv = a.in[6]; const float* conv_w = a.in[7];
    const float* g_attn = a.in[8]; const float* g_conv = a.in[9]; const float* g_xattn = a.in[10]; const float* w_out = a.in[11]; const float* g_post_mix = a.in[12];
    const float* g_pre_mlp = a.in[13]; const float* w_up = a.in[14]; const float* w_dn = a.in[15]; const float* g_post_mlp = a.in[16];
    float* out = a.out;
    bf16* Wt_in = (bf16*)(ws + WS_WIN); bf16* Wt_out = (bf16*)(ws + WS_WOUT); bf16* Wt_up = (bf16*)(ws + WS_WUP); bf16* Wt_dn = (bf16*)(ws + WS_WDN);
    float* ROPE = (float*)(ws + WS_ROPE); bf16* MKV = (bf16*)(ws + WS_MKV); float* LSE = (float*)(ws + WS_LSE);
    bf16* XN = (bf16*)(ws + WS_XN); bf16* H2 = (bf16*)(ws + WS_H2); bf16* PROJ = (bf16*)(ws + WS_PROJ); bf16* OG = (bf16*)(ws + WS_OG);
    bf16* YX = (bf16*)(ws + WS_YX); bf16* Y = (bf16*)(ws + WS_Y); float* YO = (float*)(ws + WS_YO); bf16* HB = (bf16*)(ws + WS_HB); float* FO = (float*)(ws + WS_F);
    const int lo = a.ph_lo, hi_ph = a.ph_hi;
#define IN(k) (lo <= (k) && (k) < hi_ph)
#define SEAM(k) do { if (IN(k) && IN((k) + 1)) cg::this_grid().sync(); } while (0)

    if (IN(0)) {
        LAS float* scr = (LAS float*)(lds + wave * 16384);
        constexpr int I_IN = (DM / 64) * (NPROJ / 32), I_MKV = (DM / 64) * (NMKV / 32), I_OUT = (DM / 64) * (DM / 32), I_UP = (DM / 64) * (FF / 32), I_DN = (FF / 64) * (DM / 32);
        constexpr int NITEMS = I_IN + I_MKV + I_OUT + I_UP + I_DN;
        for (int it = gw; it < NITEMS; it += NGW) {
            int r = it;
            if (r < I_IN) { transpose_item<true>(w_in, DM, NPROJ, Wt_in, scr, r, lane); continue; } r -= I_IN;
            if (r < I_MKV) { transpose_item<false>(w_mkv, DM, NMKV, Wt_in + (size_t)NPROJ * DM, scr, r, lane); continue; } r -= I_MKV;
            if (r < I_OUT) { transpose_item<false>(w_out, DM, DM, Wt_out, scr, r, lane); continue; } r -= I_OUT;
            if (r < I_UP) { transpose_item<false>(w_up, DM, FF, Wt_up, scr, r, lane); continue; } r -= I_UP;
            transpose_item<false>(w_dn, FF, DM, Wt_dn, scr, r, lane);
        }
        for (int mrow = gw; mrow < M + MMEM; mrow += NGW) {
            if (mrow < M) rms_row_to_bf16(x + (size_t)mrow * DM, g_pre_mix, XN + (size_t)mrow * DM, lane);
            else rms_row_to_bf16(mem + (size_t)(mrow - M) * DM, g_mem, XN + (size_t)mrow * DM, lane);
        }
        for (int idx = bx * NTHR + tid; idx < M * 32; idx += G * NTHR) {
            const int tok = idx >> 5, i = idx & 31;
            const float inv = (float)exp2(-(double)i * (13.287712379549449 / 32.0));
            const float ang = (float)pos[tok] * inv;
            const double rev = (double)ang * 0.15915494309189535;
            const float fr = (float)(rev - rint(rev));
            ROPE[2 * idx] = __builtin_amdgcn_cosf(fr); ROPE[2 * idx + 1] = __builtin_amdgcn_sinf(fr);
        }
    }
    SEAM(0);

    if (IN(1)) {
        pg8::Gemm g{XN, Wt_in, M + MMEM, NPROJ + NMKV, DM}; SchedInProj S; S.init(G, bx);
        EpiAdapt<FInProj> E{{PROJ, MKV, ROPE}};
        pg8::gemm_phase<EpiAdapt<FInProj>, SchedInProj, true, true>(lds, g, S, E);
    }
    SEAM(1);

    if (IN(2)) {
        LAS char* vlds = (LAS char*)(lds + wave * VSTAGE_BYTES);
        constexpr int NT_DIL = 3 * BATCH * 8 * 128, NT_X = BATCH * 4 * 128;
        for (int T = gw; T < NT_DIL + NT_X; T += NGW) {
            f32x16 o[2]; float lse2;
            if (T < NT_DIL) {
                const int sb = T & 127, h = (T >> 7) & 7, b = (T >> 10) & 3, gpat = T >> 12;
                const int dsh = 2 * gpat, per = 128 >> dsh;
                const int r = sb / per, i0 = (sb % per) * 32;
                const int jstart = i0 < 128 ? (128 - i0) / 32 : 0;
                const int ntile = 5 - jstart, kidx0 = i0 - 128 + 32 * jstart;
                const size_t rowb = (size_t)b * SEQ;
                const size_t qtok = rowb + ((size_t)(i0 + (lane & 31)) << dsh) + r;
                const size_t ktok0 = rowb + ((size_t)kidx0 << dsh) + r;
                const long kstride = (long)NPROJ << dsh;
                attn_core(PROJ + qtok * NPROJ + h * 64, PROJ + ktok0 * NPROJ + C_K + h * 64, PROJ + ktok0 * NPROJ + C_V + h * 64, kstride, ntile, jstart == 0 ? 0 : -1, ntile - 1, vlds, lane, o, lse2);
                attn_store(OG + ((size_t)gpat * M + qtok) * 512 + h * 64, o, lane >> 5);
                if (lane < 32) LSE[((size_t)gpat * M + qtok) * 8 + h] = lse2;
            } else {
                const int C = T - NT_DIL, qb = C & 127, h = (C >> 7) & 3, b = C >> 9;
                const size_t qtok = (size_t)b * SEQ + qb * 32 + (lane & 31);
                const bf16* kb = MKV + (size_t)b * NMEM * NMKV + h * 64;
                attn_core(PROJ + qtok * NPROJ + C_QX + h * 64, kb, kb + 256, (long)NMKV, 8, -1, -1, vlds, lane, o, lse2);
                attn_store(YX + qtok * 256 + h * 64, o, lane >> 5);
            }
        }
    }
    SEAM(2);

    if (IN(3)) {
        for (int row = gw; row < M; row += NGW) {
            float ya[8];
            {
                const int h = lane >> 3;
                const float l0 = LSE[((size_t)0 * M + row) * 8 + h], l1 = LSE[((size_t)1 * M + row) * 8 + h], l2 = LSE[((size_t)2 * M + row) * 8 + h];
                const float mx = fmaxf(l0, fmaxf(l1, l2));
                float w0 = __builtin_amdgcn_exp2f(l0 - mx), w1 = __builtin_amdgcn_exp2f(l1 - mx), w2 = __builtin_amdgcn_exp2f(l2 - mx);
                const float iw = 1.0f / (w0 + w1 + w2); w0 *= iw; w1 *= iw; w2 *= iw;
                const u32x4 a0 = *(const u32x4*)(OG + ((size_t)0 * M + row) * 512 + 8 * lane), a1 = *(const u32x4*)(OG + ((size_t)1 * M + row) * 512 + 8 * lane), a2 = *(const u32x4*)(OG + ((size_t)2 * M + row) * 512 + 8 * lane);
#pragma unroll
                for (int e = 0; e < 4; ++e) { ya[2 * e] = w0 * bflo(a0[e]) + w1 * bflo(a1[e]) + w2 * bflo(a2[e]); ya[2 * e + 1] = w0 * bfhi(a0[e]) + w1 * bfhi(a1[e]) + w2 * bfhi(a2[e]); }
            }
            float ssa = 0.f;
#pragma unroll
            for (int e = 0; e < 8; ++e) ssa += ya[e] * ya[e];
            float yc[4];
            {
                const int s = row & (SEQ - 1);
                const f32x4 cw0 = *(const f32x4*)(conv_w + 4 * lane), cw1 = *(const f32x4*)(conv_w + 256 + 4 * lane), cw2 = *(const f32x4*)(conv_w + 512 + 4 * lane);
                float acc[4] = {0.f, 0.f, 0.f, 0.f};
#pragma unroll
                for (int tap = 0; tap < 3; ++tap) {
                    const int back = 2 - tap;
                    if (s >= back) {
                        const bf16* pr = PROJ + (size_t)(row - back) * NPROJ;
                        const u32x2 cg = *(const u32x2*)(pr + C_C + 4 * lane), uu = *(const u32x2*)(pr + C_U + 4 * lane);
                        const f32x4 w = tap == 0 ? cw0 : (tap == 1 ? cw1 : cw2);
                        acc[0] += w[0] * (bflo(cg.x) * bflo(uu.x)); acc[1] += w[1] * (bfhi(cg.x) * bfhi(uu.x));
                        acc[2] += w[2] * (bflo(cg.y) * bflo(uu.y)); acc[3] += w[3] * (bfhi(cg.y) * bfhi(uu.y));
                    }
                }
                const u32x2 bg = *(const u32x2*)(PROJ + (size_t)row * NPROJ + C_B + 4 * lane);
                yc[0] = bflo(bg.x) * acc[0]; yc[1] = bfhi(bg.x) * acc[1]; yc[2] = bflo(bg.y) * acc[2]; yc[3] = bfhi(bg.y) * acc[3];
            }
            float ssc = (yc[0] * yc[0] + yc[1] * yc[1]) + (yc[2] * yc[2] + yc[3] * yc[3]);
            float yx[4];
            { const u32x2 v = *(const u32x2*)(YX + (size_t)row * 256 + 4 * lane); yx[0] = bflo(v.x); yx[1] = bfhi(v.x); yx[2] = bflo(v.y); yx[3] = bfhi(v.y); }
            float ssx = (yx[0] * yx[0] + yx[1] * yx[1]) + (yx[2] * yx[2] + yx[3] * yx[3]);
            ssa = wave_sum(ssa); ssc = wave_sum(ssc); ssx = wave_sum(ssx);
            const float ra = 1.0f / sqrtf(ssa * (1.f / 512.f) + EPS), rc = 1.0f / sqrtf(ssc * (1.f / 256.f) + EPS), rx = 1.0f / sqrtf(ssx * (1.f / 256.f) + EPS);
            bf16* yrow = Y + (size_t)row * DM;
            { const f32x4 g0 = *(const f32x4*)(g_attn + 8 * lane), g1 = *(const f32x4*)(g_attn + 8 * lane + 4);
              u32x4 w; w.x = pk2(ya[0] * ra * g0[0], ya[1] * ra * g0[1]); w.y = pk2(ya[2] * ra * g0[2], ya[3] * ra * g0[3]); w.z = pk2(ya[4] * ra * g1[0], ya[5] * ra * g1[1]); w.w = pk2(ya[6] * ra * g1[2], ya[7] * ra * g1[3]);
              *(u32x4*)(yrow + 8 * lane) = w; }
            { const f32x4 g0 = *(const f32x4*)(g_conv + 4 * lane); u32x2 w; w.x = pk2(yc[0] * rc * g0[0], yc[1] * rc * g0[1]); w.y = pk2(yc[2] * rc * g0[2], yc[3] * rc * g0[3]); *(u32x2*)(yrow + 512 + 4 * lane) = w; }
            { const f32x4 g0 = *(const f32x4*)(g_xattn + 4 * lane); u32x2 w; w.x = pk2(yx[0] * rx * g0[0], yx[1] * rx * g0[1]); w.y = pk2(yx[2] * rx * g0[2], yx[3] * rx * g0[3]); *(u32x2*)(yrow + 768 + 4 * lane) = w; }
        }
    }
    SEAM(3);

    if (IN(4)) {
        pg8::Gemm g{Y, Wt_out, M, DM, DM}; pg8::StaticOrder S; S.init(M, DM, G, bx);
        EpiAdapt<FF32> E{{YO, DM}};
        pg8::gemm_phase<EpiAdapt<FF32>, pg8::StaticOrder, true, true>(lds, g, S, E);
    }
    SEAM(4);

    if (IN(5)) {
        for (int row = gw; row < M; row += NGW) {
            const f32x4* yr = (const f32x4*)(YO + (size_t)row * DM) + lane; const f32x4* xr = (const f32x4*)(x + (size_t)row * DM) + lane;
            f32x4 v[4], xv[4]; float s = 0.f;
#pragma unroll
            for (int j = 0; j < 4; ++j) { v[j] = yr[64 * j]; xv[j] = xr[64 * j]; s += (v[j].x * v[j].x + v[j].y * v[j].y) + (v[j].z * v[j].z + v[j].w * v[j].w); }
            const float r1 = 1.0f / sqrtf(wave_sum(s) * (1.f / DM) + EPS);
            float s2 = 0.f;
#pragma unroll
            for (int j = 0; j < 4; ++j) { const f32x4 gg = ((const f32x4*)g_post_mix)[lane + 64 * j]; v[j] = xv[j] + v[j] * r1 * gg; s2 += (v[j].x * v[j].x + v[j].y * v[j].y) + (v[j].z * v[j].z + v[j].w * v[j].w); }
            const float r2 = 1.0f / sqrtf(wave_sum(s2) * (1.f / DM) + EPS);
            f32x4* orow = (f32x4*)(out + (size_t)row * DM) + lane; u32x2* hrow = (u32x2*)(H2 + (size_t)row * DM) + lane;
#pragma unroll
            for (int j = 0; j < 4; ++j) { orow[64 * j] = v[j]; const f32x4 gg = ((const f32x4*)g_pre_mlp)[lane + 64 * j];
                u32x2 w; w.x = pk2(v[j].x * r2 * gg.x, v[j].y * r2 * gg.y); w.y = pk2(v[j].z * r2 * gg.z, v[j].w * r2 * gg.w); hrow[64 * j] = w; }
        }
    }
    SEAM(5);

    if (IN(6)) {
        pg8::Gemm g{H2, Wt_up, M, FF, DM}; pg8::StaticOrder S; S.init(M, FF, G, bx);
        EpiAdapt<FRelu2> E{{HB, FF}};
        pg8::gemm_phase<EpiAdapt<FRelu2>, pg8::StaticOrder, true, true>(lds, g, S, E);
    }
    SEAM(6);

    if (IN(7)) {
        pg8::Gemm g{HB, Wt_dn, M, DM, FF}; pg8::StaticOrder S; S.init(M, DM, G, bx);
        EpiAdapt<FF32> E{{FO, DM}};
        pg8::gemm_phase<EpiAdapt<FF32>, pg8::StaticOrder, true, true>(lds, g, S, E);
    }
    SEAM(7);

    if (IN(8)) {
        for (int row = gw; row < M; row += NGW) {
            const f32x4* fr = (const f32x4*)(FO + (size_t)row * DM) + lane; f32x4* orow = (f32x4*)(out + (size_t)row * DM) + lane;
            f32x4 v[4], xv[4]; float s = 0.f;
#pragma unroll
            for (int j = 0; j < 4; ++j) { v[j] = fr[64 * j]; xv[j] = orow[64 * j]; s += (v[j].x * v[j].x + v[j].y * v[j].y) + (v[j].z * v[j].z + v[j].w * v[j].w); }
            const float r1 = 1.0f / sqrtf(wave_sum(s) * (1.f / DM) + EPS);
#pragma unroll
            for (int j = 0; j < 4; ++j) { const f32x4 gg = ((const f32x4*)g_post_mlp)[lane + 64 * j]; orow[64 * j] = xv[j] + v[j] * r1 * gg; }
        }
    }
#undef IN
#undef SEAM
}

extern "C" void kernel_launch(void* const* d_in, const int* in_sizes, int n_in, void* d_out, int out_size, void* d_ws, size_t ws_size, hipStream_t stream) {
    static int grid = 0;
    if (grid == 0) {
        if (n_in != 17 || in_sizes[0] != M * DM || out_size != M * DM || ws_size < WS_END) { fprintf(stderr, "kernel_launch: unexpected shapes (n_in %d in0 %d out %d ws %zu)\n", n_in, n_in > 0 ? in_sizes[0] : -1, out_size, ws_size); grid = -1; return; }
        int dev = 0, cus = 0, per_cu = 0;
        hipGetDevice(&dev); hipDeviceGetAttribute(&cus, hipDeviceAttributeMultiprocessorCount, dev);
        if (hipFuncSetAttribute((const void*)mega, hipFuncAttributeMaxDynamicSharedMemorySize, LDS_BYTES) != hipSuccess) { fprintf(stderr, "kernel_launch: hipFuncSetAttribute failed\n"); grid = -1; return; }
        if (hipOccupancyMaxActiveBlocksPerMultiprocessor(&per_cu, (const void*)mega, NTHR, LDS_BYTES) != hipSuccess || per_cu < 1) { fprintf(stderr, "kernel_launch: occupancy query gave %d\n", per_cu); per_cu = 1; }
        (void)hipGetLastError();
        grid = cus * per_cu;
        fprintf(stderr, "kernel_launch: grid %d (cus %d x %d)\n", grid, cus, per_cu);
    }
    if (grid < 0) return;
    Args a{};
    for (int i = 0; i < 17; ++i) a.in[i] = (const float*)d_in[i];
    a.out = (float*)d_out; a.ws = (unsigned char*)d_ws;
#if MK_N_LAUNCHES == 1
    a.ph_lo = 0; a.ph_hi = NPH;
    void* args[] = {&a};
    hipError_t e = hipLaunchCooperativeKernel((const void*)mega, dim3(grid), dim3(NTHR), args, LDS_BYTES, stream);
    if (e != hipSuccess) fprintf(stderr, "kernel_launch: cooperative launch failed: %s (grid %d)\n", hipGetErrorString(e), grid);
#else
    for (int ph = 0; ph < NPH; ++ph) {
        a.ph_lo = ph; a.ph_hi = ph + 1;
        hipLaunchKernelGGL(mega, dim3(grid), dim3(NTHR), LDS_BYTES, stream, a);
    }
#endif
}
```
